# Optimizing an MI355X kernel written in HIP

```python
import math
import jax, jax.numpy as jnp
from jax import lax
import numpy as np

D_MODEL = 1024
BATCH = 8
SEQ = 2048
DEPTH = 2

HEAD_DIM = 64
CONV_WIDTH = 256
CONV_K = 3
GDN_HEADS = 4
GDN_WIDTH = GDN_HEADS * HEAD_DIM
GDN_CONV_K = 4
GDN_CHUNK = 64
NSA_Q_HEADS = 8
NSA_KV_HEADS = 2
NSA_GROUP = NSA_Q_HEADS // NSA_KV_HEADS
NSA_WIDTH = NSA_Q_HEADS * HEAD_DIM
NSA_KV_WIDTH = 6 * NSA_KV_HEADS * HEAD_DIM
CMP_LEN = 32
CMP_STRIDE = 16
CMP_HIDDEN = 2 * HEAD_DIM
SEL_BLOCK = 64
SEL_TOPN = 8
WINDOW = 512
Q_BLOCK = 128
FORCE_BONUS = 1e3
MIX_WIDTH = CONV_WIDTH + GDN_WIDTH + NSA_WIDTH
IN_SIZES = (CONV_WIDTH, CONV_WIDTH, CONV_WIDTH,
            3 * GDN_WIDTH, GDN_WIDTH, GDN_HEADS, GDN_HEADS,
            NSA_WIDTH, NSA_KV_WIDTH, 3 * NSA_Q_HEADS)
IN_WIDTH = 3 * CONV_WIDTH + 4 * GDN_WIDTH + 2 * GDN_HEADS + NSA_WIDTH + NSA_KV_WIDTH + 3 * NSA_Q_HEADS
D_FF = 2816
DEEPNORM_ALPHA = (2 * DEPTH) ** 0.25
DEEPNORM_BETA = (8 * DEPTH) ** -0.25
LN_EPS = 1e-5
NORM_EPS = 1e-6
NEG = -1e30

kernel_name = "hymba_style_conv_gdn_nsa_macaron_deepnorm"


def layer_norm(x, g, b):
    xf = x.astype(jnp.float32)
    mu = jnp.mean(xf, -1, keepdims=True)
    var = jnp.mean(jnp.square(xf - mu), -1, keepdims=True)
    return ((xf - mu) * lax.rsqrt(var + LN_EPS) * g.astype(jnp.float32) + b.astype(jnp.float32)).astype(x.dtype)


def swiglu(x, w_gate, w_up, w_down):
    return (jax.nn.silu(x @ w_gate) * (x @ w_up)) @ w_down


def causal_dwconv(u, w):
    k = w.shape[-1]
    s = u.shape[1]
    u_pad = jnp.pad(u, ((0, 0), (k - 1, 0), (0, 0)))
    y = u_pad[:, 0:s] * w[:, 0]
    for j in range(1, k):
        y = y + u_pad[:, j:j + s] * w[:, j]
    return y


def l2norm(t):
    return t * lax.rsqrt(jnp.sum(t * t, -1, keepdims=True) + NORM_EPS)


def split_columns(h, sizes):
    out, start = [], 0
    for n in sizes:
        out.append(h[..., start:start + n])
        start += n
    return out


def short_conv_mixer(b_gate, c_gate, h, conv_w):
    return b_gate * causal_dwconv(c_gate * h, conv_w)


def gated_deltanet(qkv, z, a, b, conv_w, a_log, dt_bias, norm_w):
    f32 = jnp.float32
    bsz, s, _ = qkv.shape
    dtype = qkv.dtype
    c = GDN_CHUNK
    nc = s // c
    qkv = jax.nn.silu(causal_dwconv(qkv, conv_w)).astype(f32)
    q, k, v = jnp.split(qkv, 3, axis=-1)
    to_heads = lambda t: t.reshape(bsz, s, GDN_HEADS, HEAD_DIM).transpose(0, 2, 1, 3)
    q = l2norm(to_heads(q)) * HEAD_DIM ** -0.5
    k = l2norm(to_heads(k))
    v = to_heads(v)
    beta = jax.nn.sigmoid(b.astype(f32)).transpose(0, 2, 1)
    g = (-jnp.exp(a_log.astype(f32)) * jax.nn.softplus(a.astype(f32) + dt_bias.astype(f32))).transpose(0, 2, 1)
    chunk = lambda t: t.reshape(bsz, GDN_HEADS, nc, c, *t.shape[3:])
    q, k, v, beta, g = chunk(q), chunk(k), chunk(v), chunk(beta), chunk(g)
    gc = jnp.cumsum(g, axis=-1)
    tril = jnp.tril(jnp.ones((c, c), bool))
    strict = jnp.tril(jnp.ones((c, c), bool), -1)
    diff = gc[..., :, None] - gc[..., None, :]
    decay = jnp.where(tril, jnp.exp(jnp.where(tril, diff, 0.0)), 0.0)
    kb = k * beta[..., None]
    vb = v * beta[..., None]
    lmat = jnp.where(strict, jnp.einsum('bhnid,bhnjd->bhnij', kb, k) * decay, 0.0)
    eye = jnp.eye(c, dtype=f32)
    tinv = lax.linalg.triangular_solve(lmat + eye, jnp.broadcast_to(eye, lmat.shape),
                                       left_side=True, lower=True, unit_diagonal=True)
    u = jnp.einsum('bhnij,bhnjd->bhnid', tinv, vb)
    w = jnp.einsum('bhnij,bhnjd->bhnid', tinv, kb * jnp.exp(gc)[..., None])
    a_qk = jnp.where(tril, jnp.einsum('bhnid,bhnjd->bhnij', q, k) * decay, 0.0)
    g_last = gc[..., -1]
    q_dec = q * jnp.exp(gc)[..., None]
    k_dec = k * jnp.exp(g_last[..., None] - gc)[..., None]

    def step(state, xs):
        q_i, k_i, u_i, w_i, a_i, gl_i = xs
        v_new = u_i - jnp.einsum('bhck,bhkv->bhcv', w_i, state)
        o = jnp.einsum('bhck,bhkv->bhcv', q_i, state) + jnp.einsum('bhij,bhjv->bhiv', a_i, v_new)
        state = state * jnp.exp(gl_i)[..., None, None] + jnp.einsum('bhck,bhcv->bhkv', k_i, v_new)
        return state, o

    xs = tuple(jnp.moveaxis(t, 2, 0) for t in (q_dec, k_dec, u, w, a_qk, g_last))
    state0 = jnp.zeros((bsz, GDN_HEADS, HEAD_DIM, HEAD_DIM), f32)
    _, o = lax.scan(step, state0, xs)
    o = jnp.moveaxis(o, 0, 2).reshape(bsz, GDN_HEADS, s, HEAD_DIM).transpose(0, 2, 1, 3)
    o = o * lax.rsqrt(jnp.mean(o * o, -1, keepdims=True) + NORM_EPS) * norm_w.astype(f32)
    o = o * jax.nn.silu(z.astype(f32).reshape(bsz, s, GDN_HEADS, HEAD_DIM))
    return o.reshape(bsz, s, GDN_WIDTH).astype(dtype)


def nsa_attention(q, kv, gates, pe_k, pe_v, ck_w1, ck_w2, cv_w1, cv_w2):
    f32 = jnp.float32
    bsz, s, _ = q.shape
    dtype = q.dtype
    hk, grp, d = NSA_KV_HEADS, NSA_GROUP, HEAD_DIM
    scale = HEAD_DIM ** -0.5
    q = q.reshape(bsz, s, hk, grp, d).transpose(0, 2, 3, 1, 4)
    kv = kv.reshape(bsz, s, 6, hk, d)
    k_cmp, v_cmp, k_slc, v_slc, k_win, v_win = (kv[:, :, i] for i in range(6))
    t_pos = jnp.arange(s)

    n_cmp = (s - CMP_LEN) // CMP_STRIDE + 1
    starts = jnp.arange(n_cmp) * CMP_STRIDE
    blk_idx = starts[:, None] + jnp.arange(CMP_LEN)[None, :]

    def compress(t, pe, w1, w2):
        blocks = t[:, blk_idx] + pe[None, None, :, None, :]
        flat = blocks.transpose(0, 1, 3, 2, 4).reshape(bsz, n_cmp, hk, CMP_LEN * d)
        return jax.nn.silu(flat @ w1) @ w2

    kc = compress(k_cmp, pe_k, ck_w1, ck_w2)
    vc = compress(v_cmp, pe_v, cv_w1, cv_w2)
    s_cmp = jnp.einsum('bhgtd,bnhd->bhgtn', q, kc).astype(f32) * scale
    cmp_ok = (starts + CMP_LEN - 1)[None, :] <= t_pos[:, None]
    p_cmp = jax.nn.softmax(jnp.where(cmp_ok, s_cmp, NEG), axis=-1)
    p_cmp = jnp.where(cmp_ok.any(-1)[:, None], p_cmp, 0.0)
    o_cmp = jnp.einsum('bhgtn,bnhd->bhgtd', p_cmp.astype(dtype), vc)

    n_sel = s // SEL_BLOCK
    n_top = min(SEL_TOPN, n_sel)
    cmp_tok = (t_pos[None, :] >= starts[:, None]) & (t_pos[None, :] < starts[:, None] + CMP_LEN)
    sel_tok = (t_pos[None, :] // SEL_BLOCK) == jnp.arange(n_sel)[:, None]
    overlap = (cmp_tok.astype(f32) @ sel_tok.astype(f32).T) / CMP_LEN
    imp = jnp.einsum('bhgtn,nj->bhtj', p_cmp, overlap)
    q_blk = t_pos // SEL_BLOCK
    j = jnp.arange(n_sel)
    forced = (j[None, :] == 0) | (j[None, :] == q_blk[:, None]) | (j[None, :] == q_blk[:, None] - 1)
    imp = jnp.where(forced, imp + FORCE_BONUS, imp)
    imp = jnp.where(j[None, :] <= q_blk[:, None], imp, NEG)
    _, sel_idx = lax.top_k(imp, n_top)

    kb_slc = k_slc.reshape(bsz, n_sel, SEL_BLOCK, hk, d).transpose(0, 3, 1, 2, 4)
    vb_slc = v_slc.reshape(bsz, n_sel, SEL_BLOCK, hk, d).transpose(0, 3, 1, 2, 4)
    kw = jnp.pad(k_win.transpose(0, 2, 1, 3), ((0, 0), (0, 0), (WINDOW, 0), (0, 0)))
    vw = jnp.pad(v_win.transpose(0, 2, 1, 3), ((0, 0), (0, 0), (WINDOW, 0), (0, 0)))
    n_qb = s // Q_BLOCK
    b_ix = jnp.arange(bsz)[:, None, None, None]
    h_ix = jnp.arange(hk)[None, :, None, None]

    def block_attn(args):
        qb, idx, i = args
        tq = i * Q_BLOCK + jnp.arange(Q_BLOCK)
        kg = kb_slc[b_ix, h_ix, idx].reshape(bsz, hk, Q_BLOCK, n_top * SEL_BLOCK, d)
        vg = vb_slc[b_ix, h_ix, idx].reshape(bsz, hk, Q_BLOCK, n_top * SEL_BLOCK, d)
        kpos = (idx[..., None] * SEL_BLOCK + jnp.arange(SEL_BLOCK)).reshape(bsz, hk, Q_BLOCK, n_top * SEL_BLOCK)
        ok = kpos <= tq[None, None, :, None]
        sc = jnp.einsum('bhgqd,bhqkd->bhgqk', qb, kg).astype(f32) * scale
        ps = jax.nn.softmax(jnp.where(ok[:, :, None], sc, NEG), axis=-1)
        o_s = jnp.einsum('bhgqk,bhqkd->bhgqd', ps.astype(dtype), vg)
        kwin = lax.dynamic_slice_in_dim(kw, i * Q_BLOCK, WINDOW + Q_BLOCK, axis=2)
        vwin = lax.dynamic_slice_in_dim(vw, i * Q_BLOCK, WINDOW + Q_BLOCK, axis=2)
        wpos = i * Q_BLOCK - WINDOW + jnp.arange(WINDOW + Q_BLOCK)
        dist = tq[:, None] - wpos[None, :]
        wok = (dist >= 0) & (dist < WINDOW) & (wpos[None, :] >= 0)
        sw = jnp.einsum('bhgqd,bhkd->bhgqk', qb, kwin).astype(f32) * scale
        pw = jax.nn.softmax(jnp.where(wok, sw, NEG), axis=-1)
        o_w = jnp.einsum('bhgqk,bhkd->bhgqd', pw.astype(dtype), vwin)
        return o_s, o_w

    q_blocks = q.reshape(bsz, hk, grp, n_qb, Q_BLOCK, d).transpose(3, 0, 1, 2, 4, 5)
    idx_blocks = sel_idx.reshape(bsz, hk, n_qb, Q_BLOCK, n_top).transpose(2, 0, 1, 3, 4)
    o_slc, o_win = lax.map(block_attn, (q_blocks, idx_blocks, jnp.arange(n_qb)))
    unblock = lambda o: o.transpose(1, 2, 3, 0, 4, 5).reshape(bsz, hk, grp, s, d)
    to_tokens = lambda o: o.transpose(0, 3, 1, 2, 4).reshape(bsz, s, NSA_Q_HEADS, d)
    gt = jax.nn.sigmoid(gates.astype(f32)).reshape(bsz, s, NSA_Q_HEADS, 3).astype(dtype)
    o = (gt[..., 0:1] * to_tokens(o_cmp) + gt[..., 1:2] * to_tokens(unblock(o_slc))
         + gt[..., 2:3] * to_tokens(unblock(o_win)))
    return o.reshape(bsz, s, NSA_WIDTH)


def hybrid_mixer(x, w_in, conv_w, gdn_conv_w, gdn_a_log, gdn_dt_bias, gdn_norm_w,
                 cmp_pe_k, cmp_pe_v, cmp_k_w1, cmp_k_w2, cmp_v_w1, cmp_v_w2, w_out):
    h = x @ w_in
    cb, cc, ch, gqkv, gz, ga, gb, nq, nkv, ngate = split_columns(h, IN_SIZES)
    y_a = short_conv_mixer(cb, cc, ch, conv_w)
    y_b = gated_deltanet(gqkv, gz, ga, gb, gdn_conv_w, gdn_a_log, gdn_dt_bias, gdn_norm_w)
    y_c = nsa_attention(nq, nkv, ngate, cmp_pe_k, cmp_pe_v, cmp_k_w1, cmp_k_w2, cmp_v_w1, cmp_v_w2)
    return jnp.concatenate([y_a, y_b, y_c], axis=-1) @ w_out


def setup_inputs(seed: int = 0) -> dict:
    key = jax.random.key(seed)
    keys = jax.random.split(key, 26)
    f32 = jnp.float32
    L = DEPTH

    def nrm(i, shape, scale):
        return jax.random.normal(keys[i], shape, f32) * scale

    dt = jnp.exp(jax.random.uniform(keys[10], (L, GDN_HEADS), f32, math.log(1e-3), math.log(1e-1)))
    return {
        "x": nrm(0, (BATCH, SEQ, D_MODEL), 1.0),
        "ffn1_w_gate": nrm(1, (L, D_MODEL, D_FF), D_MODEL ** -0.5),
        "ffn1_w_up": nrm(2, (L, D_MODEL, D_FF), D_MODEL ** -0.5),
        "ffn1_w_down": nrm(3, (L, D_FF, D_MODEL), D_FF ** -0.5 * DEEPNORM_BETA),
        "ln1_g": 1.0 + nrm(4, (L, D_MODEL), 0.02),
        "ln1_b": nrm(5, (L, D_MODEL), 0.02),
        "w_in": nrm(6, (L, D_MODEL, IN_WIDTH), D_MODEL ** -0.5),
        "conv_w": nrm(7, (L, CONV_WIDTH, CONV_K), CONV_K ** -0.5),
        "gdn_conv_w": nrm(8, (L, 3 * GDN_WIDTH, GDN_CONV_K), GDN_CONV_K ** -0.5),
        "gdn_a_log": jnp.log(jax.random.uniform(keys[9], (L, GDN_HEADS), f32, 1.0, 16.0)),
        "gdn_dt_bias": dt + jnp.log(-jnp.expm1(-dt)),
        "gdn_norm_w": 1.0 + nrm(11, (L, HEAD_DIM), 0.02),
        "cmp_pe_k": nrm(12, (L, CMP_LEN, HEAD_DIM), 0.1),
        "cmp_pe_v": nrm(13, (L, CMP_LEN, HEAD_DIM), 0.1),
        "cmp_k_w1": nrm(14, (L, CMP_LEN * HEAD_DIM, CMP_HIDDEN), (CMP_LEN * HEAD_DIM) ** -0.5),
        "cmp_k_w2": nrm(15, (L, CMP_HIDDEN, HEAD_DIM), CMP_HIDDEN ** -0.5),
        "cmp_v_w1": nrm(16, (L, CMP_LEN * HEAD_DIM, CMP_HIDDEN), (CMP_LEN * HEAD_DIM) ** -0.5),
        "cmp_v_w2": nrm(17, (L, CMP_HIDDEN, HEAD_DIM), CMP_HIDDEN ** -0.5),
        "w_out": nrm(18, (L, MIX_WIDTH, D_MODEL), MIX_WIDTH ** -0.5 * DEEPNORM_BETA),
        "ln2_g": 1.0 + nrm(19, (L, D_MODEL), 0.02),
        "ln2_b": nrm(20, (L, D_MODEL), 0.02),
        "ffn2_w_gate": nrm(21, (L, D_MODEL, D_FF), D_MODEL ** -0.5),
        "ffn2_w_up": nrm(22, (L, D_MODEL, D_FF), D_MODEL ** -0.5),
        "ffn2_w_down": nrm(23, (L, D_FF, D_MODEL), D_FF ** -0.5 * DEEPNORM_BETA),
        "ln3_g": 1.0 + nrm(24, (L, D_MODEL), 0.02),
        "ln3_b": nrm(25, (L, D_MODEL), 0.02),
    }


def reference(x, ffn1_w_gate, ffn1_w_up, ffn1_w_down, ln1_g, ln1_b, w_in, conv_w, gdn_conv_w,
              gdn_a_log, gdn_dt_bias, gdn_norm_w, cmp_pe_k, cmp_pe_v, cmp_k_w1, cmp_k_w2,
              cmp_v_w1, cmp_v_w2, w_out, ln2_g, ln2_b, ffn2_w_gate, ffn2_w_up, ffn2_w_down,
              ln3_g, ln3_b):
    for l in range(DEPTH):
        x = layer_norm(DEEPNORM_ALPHA * x + 0.5 * swiglu(x, ffn1_w_gate[l], ffn1_w_up[l], ffn1_w_down[l]),
                       ln1_g[l], ln1_b[l])
        x = layer_norm(DEEPNORM_ALPHA * x + hybrid_mixer(x, w_in[l], conv_w[l], gdn_conv_w[l], gdn_a_log[l],
                                                         gdn_dt_bias[l], gdn_norm_w[l], cmp_pe_k[l], cmp_pe_v[l],
                                                         cmp_k_w1[l], cmp_k_w2[l], cmp_v_w1[l], cmp_v_w2[l],
                                                         w_out[l]),
                       ln2_g[l], ln2_b[l])
        x = layer_norm(DEEPNORM_ALPHA * x + 0.5 * swiglu(x, ffn2_w_gate[l], ffn2_w_up[l], ffn2_w_down[l]),
                       ln3_g[l], ln3_b[l])
    return x
```

```cpp
#include <hip/hip_runtime.h>
#include <hip/hip_cooperative_groups.h>
#include <cstdio>
#include <cstdint>
#include <cmath>
namespace cg = cooperative_groups;
namespace pg8 {
#define PG8_LAS __attribute__((address_space(3)))
typedef unsigned short bf16_t;
typedef short bf16x8 __attribute__((ext_vector_type(8)));
typedef float f32x4 __attribute__((ext_vector_type(4)));
typedef unsigned u32x4 __attribute__((ext_vector_type(4)));
constexpr int BM = 256, BK = 64, HALF = 128, HTB = HALF * BK * 2  , STAGE_BYTES = 8 * HTB, NXCD = 8, WGM = 8;

__host__ __device__ __forceinline__ int lds_byte(int r, int c) { const int st = (r >> 4) * 2 + (c >> 5), rr = r & 15, cc = c & 31, ob = rr * 64 + cc * 2; return st * 1024 + (ob ^ (((ob >> 9) & 1) << 5)); }
__host__ __device__ __forceinline__ void stage_rc(int b, int& R, int& C) { const int st = b / 1024, sb = b % 1024, swz = sb ^ (((sb >> 9) & 1) << 5); R = (st >> 1) * 16 + swz / 64; C = (st & 1) * 32 + (swz % 64) / 2; }
__host__ __device__ __forceinline__ int perm32(int rho) { const int n = rho >> 4, i = rho & 15; return 8 * (i >> 2) + 4 * n + (i & 3); }

struct Unit { int pm, pn; };
struct Gemm { const bf16_t* A; const bf16_t* Bt; int M, N, K; };

struct StaticOrder {
    int nM, nN, nwg, G, c;
    __host__ __device__ void init(int M, int N, int G_, int c_) { nM = M / BM; nN = N / BM; nwg = nM * nN; G = G_; c = c_; }
    __host__ __device__ bool next(int i, Unit& u) const {
        const long L = (long)i * G + c; if (L >= nwg) return false;
        int wgid = (int)L; { const int q = nwg / NXCD, r = nwg % NXCD, xcd = wgid % NXCD, off = wgid / NXCD; wgid = (xcd < r ? xcd * (q + 1) : r * (q + 1) + (xcd - r) * q) + off; }
        const int nig = WGM * nN, gid = wgid / nig, fm = gid * WGM, gsz = (nM - fm) < WGM ? (nM - fm) : WGM;
        u.pm = fm + ((wgid % nig) % gsz); u.pn = (wgid % nig) / gsz; return true;
    }
    __device__ __forceinline__ void a_ready(const Unit&) const {}
    __device__ __forceinline__ void done(const Unit&) const {}
};

__device__ __forceinline__ unsigned cvt_pk_bf16(float lo, float hi) { unsigned r; asm volatile("v_cvt_pk_bf16_f32 %0, %1, %2" : "=v"(r) : "v"(lo), "v"(hi)); return r; }
typedef float f32x2 __attribute__((ext_vector_type(2)));
__device__ __forceinline__ int pg8_opaque_tid() { int t = threadIdx.x; asm volatile("" : "+v"(t)); return t; }
__device__ __forceinline__ float silu_f(float x) { return x * __builtin_amdgcn_rcpf(1.0f + __builtin_amdgcn_exp2f(-1.4426950408889634f * x)); }
struct EpiSwiGLU {
    static constexpr bool PERM = true, AFTER_DRAIN = false;
    bf16_t* O; int ldc;
    __device__ __forceinline__ void operator()(const f32x4 (&acc)[2][2][4][2], const Unit& u, int wr, int wc, int fr, int fq) const {
        const int row0 = u.pm * BM + wr * 64 + fr, col0 = u.pn * HALF + wc * 32 + 8 * fq;
#pragma unroll
        for (int ai = 0; ai < 2; ++ai)
#pragma unroll
            for (int m = 0; m < 4; ++m) { bf16_t* rowp = O + (size_t)(row0 + ai * HALF + m * 16) * ldc + col0;
                const f32x4 g0 = acc[ai][0][m][0], g1 = acc[ai][0][m][1], u0 = acc[ai][1][m][0], u1 = acc[ai][1][m][1];
                u32x4 w;
                w.x = cvt_pk_bf16(silu_f(g0[0]) * u0[0], silu_f(g0[1]) * u0[1]); w.y = cvt_pk_bf16(silu_f(g0[2]) * u0[2], silu_f(g0[3]) * u0[3]);
                w.z = cvt_pk_bf16(silu_f(g1[0]) * u1[0], silu_f(g1[1]) * u1[1]); w.w = cvt_pk_bf16(silu_f(g1[2]) * u1[2], silu_f(g1[3]) * u1[3]);
                *(u32x4*)rowp = w; }
    }
};
struct EpiStoreBf16 {
    static constexpr bool PERM = true, AFTER_DRAIN = false;
    bf16_t* O; int ldc;
    __device__ __forceinline__ void operator()(const f32x4 (&acc)[2][2][4][2], const Unit& u, int wr, int wc, int fr, int fq) const {
        const int row0 = u.pm * BM + wr * 64 + fr, col0 = u.pn * BM + wc * 32 + 8 * fq;
#pragma unroll
        for (int ai = 0; ai < 2; ++ai)
#pragma unroll
            for (int m = 0; m < 4; ++m) { bf16_t* rowp = O + (size_t)(row0 + ai * HALF + m * 16) * ldc + col0;
#pragma unroll
                for (int bj = 0; bj < 2; ++bj) { const f32x4 v0 = acc[ai][bj][m][0], v1 = acc[ai][bj][m][1];
                    u32x4 w; w.x = cvt_pk_bf16(v0[0], v0[1]); w.y = cvt_pk_bf16(v0[2], v0[3]); w.z = cvt_pk_bf16(v1[0], v1[1]); w.w = cvt_pk_bf16(v1[2], v1[3]);
                    *(u32x4*)(rowp + bj * HALF) = w; } }
    }
};
struct EpiRes {
    static constexpr bool PERM = false, AFTER_DRAIN = false;
    const float* R; float* O; int ldc; float alpha, c;
    __device__ __forceinline__ void operator()(const f32x4 (&acc)[2][2][4][2], const Unit& u, int wr, int wc, int fr, int fq) const {
        const int row0 = u.pm * BM + wr * 64 + fr, col0 = u.pn * BM + wc * 32 + 4 * fq;
#pragma unroll
        for (int ai = 0; ai < 2; ++ai)
#pragma unroll
            for (int m = 0; m < 4; ++m) { const size_t off = (size_t)(row0 + ai * HALF + m * 16) * ldc + col0;
#pragma unroll
                for (int bj = 0; bj < 2; ++bj)
#pragma unroll
                    for (int n = 0; n < 2; ++n) { const f32x4 r = *(const f32x4*)(R + off + bj * HALF + n * 16);
                        *(f32x4*)(O + off + bj * HALF + n * 16) = r * alpha + acc[ai][bj][m][n] * c; } }
    }
};
template <class Epi, class Sched, bool ALIGN_EPI = false, bool SP2 = false>
__device__ __forceinline__ void gemm_phase(PG8_LAS unsigned char* lds, const Gemm g, const Sched& S, const Epi& E) {
    const int tid = pg8_opaque_tid(), wid = __builtin_amdgcn_readfirstlane(tid >> 6), lane = tid & 63, wr = wid >> 2, wc = wid & 3, fr = lane & 15, fq = lane >> 4;
    const int K = g.K, nt = K / BK;
    unsigned voffA[2], voffB[2];
#pragma unroll
    for (int i = 0; i < 2; ++i) { int R, C; stage_rc(tid * 16 + i * 8192, R, C); const int Rb = Epi::PERM ? ((R & ~31) + perm32(R & 31)) : R;
        voffA[i] = (unsigned)(R * K + C) * 2u; voffB[i] = (unsigned)(Rb * K + C) * 2u; }
    const size_t kstep = (size_t)(BK * 2);
    const size_t hstep = (size_t)HALF * K * 2;
    const size_t tstep = 2 * hstep;
    const unsigned ldsw = (unsigned)wid * 1024u;
    const int aoff = lds_byte(wr * 64 + fr, fq * 8), boff = lds_byte(wc * 32 + fr, fq * 8);
#define PG8_SA(b, h) (((b) * 2 + (h)) * HTB)
#define PG8_SB(b, h) ((4 + (b) * 2 + (h)) * HTB)
#define PG8_STAGE(bufoff, gbase, voff) do { _Pragma("unroll") for (int _i = 0; _i < 2; ++_i) \
        __builtin_amdgcn_global_load_lds((const unsigned*)((const char*)(gbase) + (voff)[_i]), (PG8_LAS unsigned*)(lds + (bufoff) + ldsw + _i * 8192), 16, 0, 0); } while (0)
#define PG8_LDA(dst, b, h) do { _Pragma("unroll") for (int m = 0; m < 4; ++m) _Pragma("unroll") for (int k = 0; k < 2; ++k) dst[m][k] = *(const PG8_LAS bf16x8*)(lds + PG8_SA(b, h) + aoff + m * 2048 + k * 1024); } while (0)
#define PG8_LDB(dst, b, h) do { _Pragma("unroll") for (int n = 0; n < 2; ++n) _Pragma("unroll") for (int k = 0; k < 2; ++k) dst[n][k] = *(const PG8_LAS bf16x8*)(lds + PG8_SB(b, h) + boff + n * 2048 + k * 1024); } while (0)
#define PG8_MMA(ai, bj, At, Bt) do { __builtin_amdgcn_s_setprio(1); _Pragma("unroll") for (int m = 0; m < 4; ++m) _Pragma("unroll") for (int n = 0; n < 2; ++n) _Pragma("unroll") for (int k = 0; k < 2; ++k) \
        acc[ai][bj][m][n] = __builtin_amdgcn_mfma_f32_16x16x32_bf16(Bt[n][k], At[m][k], acc[ai][bj][m][n], 0, 0, 0); __builtin_amdgcn_s_setprio(0); } while (0)
#define PG8_WAIT_V(n) asm volatile("s_waitcnt vmcnt(" #n ")" ::: "memory")
#define PG8_WAIT_L(n) asm volatile("s_waitcnt lgkmcnt(" #n ")" ::: "memory")
#define PG8_BAR __builtin_amdgcn_s_barrier()
#define PG8_SCHED __builtin_amdgcn_sched_barrier(0)
    Unit cur, nxt; int ui = 0;
    if (!S.next(0, cur)) return;
    f32x4 acc[2][2][4][2];
#pragma unroll
    for (int a = 0; a < 2; ++a)
#pragma unroll
        for (int b = 0; b < 2; ++b)
#pragma unroll
            for (int m = 0; m < 4; ++m)
#pragma unroll
                for (int n = 0; n < 2; ++n) acc[a][b][m][n] = (f32x4){0.f, 0.f, 0.f, 0.f};
    bf16x8 At[4][2], B0[2][2], B1[2][2];
    const char* cA = (const char*)g.A + (size_t)cur.pm * tstep; const char* cB = (const char*)g.Bt + (size_t)cur.pn * tstep;
    S.a_ready(cur);
    if constexpr (SP2) {
        PG8_STAGE(PG8_SB(0, 0), cB, voffB); PG8_STAGE(PG8_SB(0, 1), cB + hstep, voffB); PG8_STAGE(PG8_SA(0, 0), cA, voffA); PG8_STAGE(PG8_SA(0, 1), cA + hstep, voffA);
        if (wr == 1) PG8_BAR;
        PG8_WAIT_V(2); PG8_BAR;
        PG8_STAGE(PG8_SB(1, 0), cB + kstep, voffB); PG8_STAGE(PG8_SA(1, 0), cA + kstep, voffA); PG8_STAGE(PG8_SB(1, 1), cB + hstep + kstep, voffB);
        PG8_WAIT_V(6); PG8_BAR;
    } else {
        PG8_STAGE(PG8_SB(0, 0), cB, voffB); PG8_STAGE(PG8_SA(0, 0), cA, voffA); PG8_STAGE(PG8_SB(0, 1), cB + hstep, voffB); PG8_STAGE(PG8_SA(0, 1), cA + hstep, voffA);
        if (wr == 1) PG8_BAR;
        PG8_WAIT_V(4); PG8_BAR;
        PG8_STAGE(PG8_SB(1, 0), cB + kstep, voffB); PG8_STAGE(PG8_SA(1, 0), cA + kstep, voffA); PG8_STAGE(PG8_SB(1, 1), cB + hstep + kstep, voffB);
        PG8_WAIT_V(6); PG8_BAR;
    }
    for (;;) {
        const bool has_next = S.next(ui + 1, nxt);
        const char* nA = has_next ? (const char*)g.A + (size_t)nxt.pm * tstep : cA; const char* nB = has_next ? (const char*)g.Bt + (size_t)nxt.pn * tstep : cB;
        for (int t = 0; t < nt; t += 2) {
            const bool last = (t == nt - 2);
            const char* a1 = cA + (size_t)(t + 1) * kstep;
            const char* a2 = last ? nA : cA + (size_t)(t + 2) * kstep; const char* b2 = last ? nB : cB + (size_t)(t + 2) * kstep;
            const char* a3 = a2 + kstep; const char* b3 = b2 + kstep;
            if (last && has_next) S.a_ready(nxt);
            if constexpr (SP2) {
            PG8_LDB(B0, 0, 0); PG8_LDB(B1, 0, 1); PG8_SCHED; PG8_LDA(At, 0, 0); PG8_STAGE(PG8_SA(1, 1), a1 + hstep, voffA);
            PG8_WAIT_V(8); PG8_WAIT_L(0); PG8_BAR; PG8_MMA(0, 0, At, B0); PG8_MMA(0, 1, At, B1); PG8_BAR; PG8_SCHED;
            PG8_LDA(At, 0, 1); PG8_STAGE(PG8_SB(0, 0), b2, voffB); PG8_STAGE(PG8_SB(0, 1), b2 + hstep, voffB); PG8_STAGE(PG8_SA(0, 0), a2, voffA);
            PG8_WAIT_V(8); PG8_WAIT_L(0); PG8_BAR; PG8_MMA(1, 0, At, B0); PG8_MMA(1, 1, At, B1); PG8_BAR; PG8_SCHED;
            PG8_LDB(B0, 1, 0); PG8_LDB(B1, 1, 1); PG8_SCHED; PG8_LDA(At, 1, 0); PG8_STAGE(PG8_SA(0, 1), a2 + hstep, voffA);
            PG8_WAIT_V(8); PG8_WAIT_L(0); PG8_BAR; PG8_MMA(0, 0, At, B0); PG8_MMA(0, 1, At, B1); PG8_BAR; PG8_SCHED;
            PG8_LDA(At, 1, 1); PG8_STAGE(PG8_SB(1, 0), b3, voffB); PG8_STAGE(PG8_SB(1, 1), b3 + hstep, voffB); PG8_STAGE(PG8_SA(1, 0), a3, voffA);
            PG8_WAIT_V(8); PG8_WAIT_L(0); PG8_BAR; PG8_MMA(1, 0, At, B0); PG8_MMA(1, 1, At, B1); PG8_BAR; PG8_SCHED;
            } else {
            PG8_LDB(B0, 0, 0); PG8_SCHED; PG8_LDA(At, 0, 0); PG8_STAGE(PG8_SA(1, 1), a1 + hstep, voffA);
            PG8_WAIT_L(8); PG8_BAR; PG8_WAIT_L(0); PG8_MMA(0, 0, At, B0); PG8_BAR; PG8_SCHED;
            PG8_LDB(B1, 0, 1); PG8_STAGE(PG8_SB(0, 0), b2, voffB);
            PG8_BAR; PG8_WAIT_L(0); PG8_MMA(0, 1, At, B1); PG8_BAR;
            PG8_LDA(At, 0, 1); PG8_STAGE(PG8_SA(0, 0), a2, voffA);
            PG8_BAR; PG8_WAIT_L(0); PG8_MMA(1, 0, At, B0); PG8_BAR; PG8_SCHED;
            PG8_STAGE(PG8_SB(0, 1), b2 + hstep, voffB);
            PG8_WAIT_V(6); PG8_BAR; PG8_MMA(1, 1, At, B1); PG8_BAR;
            PG8_LDB(B0, 1, 0); PG8_SCHED; PG8_LDA(At, 1, 0); PG8_STAGE(PG8_SA(0, 1), a2 + hstep, voffA);
            PG8_WAIT_L(8); PG8_BAR; PG8_WAIT_L(0); PG8_MMA(0, 0, At, B0); PG8_BAR; PG8_SCHED;
            PG8_LDB(B1, 1, 1); PG8_STAGE(PG8_SB(1, 0), b3, voffB);
            PG8_BAR; PG8_WAIT_L(0); PG8_MMA(0, 1, At, B1); PG8_BAR;
            PG8_LDA(At, 1, 1); PG8_STAGE(PG8_SA(1, 0), a3, voffA);
            PG8_BAR; PG8_WAIT_L(0); PG8_MMA(1, 0, At, B0); PG8_BAR; PG8_SCHED;
            PG8_STAGE(PG8_SB(1, 1), b3 + hstep, voffB);
            PG8_WAIT_V(6); PG8_BAR; PG8_MMA(1, 1, At, B1); PG8_BAR;
            }
        }
        if constexpr (ALIGN_EPI) { if (wr == 0) PG8_BAR; }
        if constexpr (!Epi::AFTER_DRAIN) { E(acc, cur, wr, wc, fr, fq); S.done(cur); }
        if (!has_next) break;
#pragma unroll
        for (int a = 0; a < 2; ++a)
#pragma unroll
            for (int b = 0; b < 2; ++b)
#pragma unroll
                for (int m = 0; m < 4; ++m)
#pragma unroll
                    for (int n = 0; n < 2; ++n) acc[a][b][m][n] = (f32x4){0.f, 0.f, 0.f, 0.f};
        cur = nxt; cA = nA; cB = nB; ++ui;
        if constexpr (ALIGN_EPI) { if (wr == 1) PG8_BAR; }
    }
    PG8_WAIT_V(0);
    if constexpr (!ALIGN_EPI) { if (wr == 0) PG8_BAR; }
    PG8_BAR;
    if constexpr (Epi::AFTER_DRAIN) { E.fused(acc, cur, wr, wc, fr, fq, lds, wid, lane); S.done(cur); }
#undef PG8_SA
#undef PG8_SB
#undef PG8_STAGE
#undef PG8_LDA
#undef PG8_LDB
#undef PG8_MMA
#undef PG8_WAIT_V
#undef PG8_WAIT_L
#undef PG8_BAR
#undef PG8_SCHED
}
}
#define LAS __attribute__((address_space(3)))
typedef unsigned short bf16;
typedef short bf16x8 __attribute__((ext_vector_type(8)));
typedef short s16x4 __attribute__((ext_vector_type(4)));
typedef float f32x4 __attribute__((ext_vector_type(4)));
typedef float f32x16 __attribute__((ext_vector_type(16)));
typedef unsigned u32x4 __attribute__((ext_vector_type(4)));

constexpr int BATCH = 8, SEQ = 2048, DM = 1024, MTOK = BATCH * SEQ, DEPTH = 2, DFF = 2816;
constexpr int INW = 3104, INP = 3328;
constexpr int C_CB = 0, C_CC = 256, C_CH = 512, C_GQ = 768, C_GK = 1024, C_GV = 1280, C_GZ = 1536, C_GA = 1792, C_GB = 1796, C_NQ = 1800, C_NKV = 2312, C_NG = 3080;
constexpr int C_KCMP = C_NKV, C_VCMP = C_NKV + 128, C_KSLC = C_NKV + 256, C_VSLC = C_NKV + 384, C_KWIN = C_NKV + 512, C_VWIN = C_NKV + 640;
constexpr float ALPHA = 1.4142135623730951f;
constexpr float LN_EPS = 1e-5f, NORM_EPS = 1e-6f;
constexpr float C2 = 0.125f * 1.4426950408889634f;
constexpr int NPH = 12;

constexpr size_t MiB = 1u << 20;
constexpr size_t WS_CTL = 0;
constexpr size_t WS_WGU1 = 1 * MiB, WS_WD1 = 12 * MiB, WS_WGU2 = 17 * MiB + MiB / 2, WS_WD2 = 28 * MiB + MiB / 2, WS_WIN = 34 * MiB, WS_WOUT = 40 * MiB + MiB / 2;
constexpr size_t WS_WCK = 42 * MiB + MiB / 2, WS_WCV = 43 * MiB, WS_PEB = 43 * MiB + MiB / 2, WS_GLAST = WS_PEB + 4096;
constexpr size_t WS_XB = 44 * MiB, WS_H = 76 * MiB, WS_GD = 180 * MiB, WS_KC = 228 * MiB, WS_VC = WS_KC + 262144, WS_END = 229 * MiB;
constexpr int GD_CHUNK = 49152;

constexpr int LDS_BYTES = 147456;
constexpr int AT_K = 0, AT_V = 16384, AT_IMPO = 32768, AT_IMPS = 41216, AT_SEL = 49664, AT_GATE = 50176, AT_WSF = 54272, AT_OST = 56320;
constexpr int GP_STRIDE = 34816;

struct Args { const float* in[26]; float* out; unsigned char* ws; int ph_lo, ph_hi; };

struct Frame {
    LAS unsigned char* lds;
    const Args* a; float* X; unsigned char* ws;
    int tid, lane, wave;
};
#define F_IN(i) (F.a->in[i])
#define F_WGU1 ((bf16*)(F.ws + WS_WGU1))
#define F_WD1 ((bf16*)(F.ws + WS_WD1))
#define F_WGU2 ((bf16*)(F.ws + WS_WGU2))
#define F_WD2 ((bf16*)(F.ws + WS_WD2))
#define F_WIN ((bf16*)(F.ws + WS_WIN))
#define F_WOUT ((bf16*)(F.ws + WS_WOUT))
#define F_WCK ((bf16*)(F.ws + WS_WCK))
#define F_WCV ((bf16*)(F.ws + WS_WCV))
#define F_XB ((bf16*)(F.ws + WS_XB))
#define F_H ((bf16*)(F.ws + WS_H))
#define F_KC ((bf16*)(F.ws + WS_KC))
#define F_VC ((bf16*)(F.ws + WS_VC))
#define F_PEB ((float*)(F.ws + WS_PEB))
#define F_GLAST ((float*)(F.ws + WS_GLAST))
#define F_GD (F.ws + WS_GD)

#define LDS_WAIT() asm volatile("s_waitcnt lgkmcnt(0)" ::: "memory")
__device__ __forceinline__ unsigned f2bf(float f) { unsigned u = __builtin_bit_cast(unsigned, f); return (u + 0x7fffu + ((u >> 16) & 1u)) >> 16; }
__device__ __forceinline__ unsigned pk2(float lo, float hi) { return f2bf(lo) | (f2bf(hi) << 16); }
__device__ __forceinline__ float bf2f(bf16 h) { return __builtin_bit_cast(float, (unsigned)h << 16); }
__device__ __forceinline__ float bflo(unsigned w) { return __builtin_bit_cast(float, w << 16); }
__device__ __forceinline__ float bfhi(unsigned w) { return __builtin_bit_cast(float, w & 0xffff0000u); }
__device__ __forceinline__ float sigmoid_f(float x) { return 1.0f / (1.0f + __expf(-x)); }
__device__ __forceinline__ float silu_f(float x) { return x / (1.0f + __expf(-x)); }
__device__ __forceinline__ float wave_sum(float v) {
#pragma unroll
    for (int o = 1; o < 64; o <<= 1) v += __shfl_xor(v, o);
    return v;
}

__device__ __forceinline__ void tr_item(const float* W, int K, int N, bf16* WT, int drow0, int k0, int n0, LAS float* scr, int lane) {
#pragma unroll 8
    for (int i = 0; i < 32; ++i) { const int kk = 2 * i + (lane >> 5); scr[kk * 33 + (lane & 31)] = W[(size_t)(k0 + kk) * N + n0 + (lane & 31)]; }
    LDS_WAIT(); asm volatile("" ::: "memory");
    const int c = lane & 7;
#pragma unroll
    for (int j = 0; j < 4; ++j) { const int n = (lane >> 3) + 8 * j; const LAS float* s = scr + (8 * c) * 33 + n;
        u32x4 o; o.x = pk2(s[0 * 33], s[1 * 33]); o.y = pk2(s[2 * 33], s[3 * 33]); o.z = pk2(s[4 * 33], s[5 * 33]); o.w = pk2(s[6 * 33], s[7 * 33]);
        *(u32x4*)(WT + (size_t)(drow0 + n) * K + k0 + 8 * c) = o; }
    LDS_WAIT(); asm volatile("" ::: "memory");
}
__device__ __forceinline__ void tr_plain(const float* W, int K, int N, bf16* WT, int item, LAS float* scr, int lane) {
    const int nblk = N / 32, kb = item / nblk, nb = item % nblk; tr_item(W, K, N, WT, 32 * nb, 64 * kb, 32 * nb, scr, lane);
}
__device__ __forceinline__ void tr_gu(const float* W, int which, bf16* WT, int item, LAS float* scr, int lane) {
    const int nblk = DFF / 32, kb = item / nblk, nb = item % nblk, n0 = 32 * nb; tr_item(W, DM, DFF, WT, (n0 >> 7) * 256 + which * 128 + (n0 & 127), 64 * kb, n0, scr, lane);
}
__device__ __forceinline__ void phase_prep(const Frame& F, int l) {
    LAS float* scr = (LAS float*)(F.lds + F.wave * 16384);
    const int gw = blockIdx.x * 8 + F.wave, NGW = gridDim.x * 8;
    constexpr int I_G = 16 * 88, I_D = 44 * 32, I_IN = 16 * 97, I_O = 16 * 32, I_C = 32 * 4;
    constexpr int NITEMS = 6 * I_G + I_IN + I_O + 2 * I_C;
    const float* g1 = F.a->in[1] + (size_t)l * DM * DFF; const float* u1 = F.a->in[2] + (size_t)l * DM * DFF; const float* d1 = F.a->in[3] + (size_t)l * DFF * DM;
    const float* g2 = F.a->in[21] + (size_t)l * DM * DFF; const float* u2 = F.a->in[22] + (size_t)l * DM * DFF; const float* d2 = F.a->in[23] + (size_t)l * DFF * DM;
    const float* win = F.a->in[6] + (size_t)l * DM * INW; const float* wout = F.a->in[18] + (size_t)l * DM * DM;
    const float* ck1 = F.a->in[14] + (size_t)l * 2048 * 128; const float* cv1 = F.a->in[16] + (size_t)l * 2048 * 128;
    for (int it = gw; it < NITEMS; it += NGW) {
        int r = it;
        if (r < I_G) { tr_gu(g1, 0, F_WGU1, r, scr, F.lane); continue; } r -= I_G;
        if (r < I_G) { tr_gu(u1, 1, F_WGU1, r, scr, F.lane); continue; } r -= I_G;
        if (r < I_D) { tr_plain(d1, DFF, DM, F_WD1, r, scr, F.lane); continue; } r -= I_D;
        if (r < I_G) { tr_gu(g2, 0, F_WGU2, r, scr, F.lane); continue; } r -= I_G;
        if (r < I_G) { tr_gu(u2, 1, F_WGU2, r, scr, F.lane); continue; } r -= I_G;
        if (r < I_D) { tr_plain(d2, DFF, DM, F_WD2, r, scr, F.lane); continue; } r -= I_D;
        if (r < I_IN) { tr_plain(win, DM, INW, F_WIN, r, scr, F.lane); continue; } r -= I_IN;
        if (r < I_O) { tr_plain(wout, DM, DM, F_WOUT, r, scr, F.lane); continue; } r -= I_O;
        if (r < I_C) { tr_plain(ck1, 2048, 128, F_WCK, r, scr, F.lane); continue; } r -= I_C;
        tr_plain(cv1, 2048, 128, F_WCV, r, scr, F.lane);
    }
    const int gt = blockIdx.x * 512 + F.tid, NGT = gridDim.x * 512;
    { u32x4* z = (u32x4*)(F_WIN + (size_t)INW * DM); const int nz = (INP - INW) * DM / 8; const u32x4 zero = {0u, 0u, 0u, 0u};
      for (int i = gt; i < nz; i += NGT) z[i] = zero; }
    if (gw < 256) { const int which = gw >> 7, j = gw & 127; const float* pe = F.a->in[which ? 13 : 12] + (size_t)l * 2048; const float* w1 = which ? cv1 : ck1;
        float s = 0.f; for (int k = F.lane; k < 2048; k += 64) s += pe[k] * w1[(size_t)k * 128 + j];
        s = wave_sum(s); if (F.lane == 0) F_PEB[gw] = s; }
    if (l == 0) { const f32x4* x4 = (const f32x4*)F.a->in[0]; u32x4* o = (u32x4*)F_XB; const int n8 = MTOK * DM / 8;
        for (int i = gt; i < n8; i += NGT) { const f32x4 a = x4[2 * i], b = x4[2 * i + 1]; u32x4 w; w.x = pk2(a.x, a.y); w.y = pk2(a.z, a.w); w.z = pk2(b.x, b.y); w.w = pk2(b.z, b.w); o[i] = w; } }
}

__device__ __forceinline__ void phase_ln(const Frame& F, const float* gam, const float* bet) {
    const int gw = blockIdx.x * 8 + F.wave, NGW = gridDim.x * 8;
    f32x4 gv[4], bv[4];
#pragma unroll
    for (int j = 0; j < 4; ++j) { gv[j] = ((const f32x4*)gam)[F.lane + 64 * j]; bv[j] = ((const f32x4*)bet)[F.lane + 64 * j]; }
    for (int m = gw; m < MTOK; m += NGW) {
        f32x4* xr = (f32x4*)(F.X + (size_t)m * DM) + F.lane;
        f32x4 v[4]; float s = 0.f;
#pragma unroll
        for (int j = 0; j < 4; ++j) { v[j] = xr[64 * j]; s += (v[j].x + v[j].y) + (v[j].z + v[j].w); }
        const float mean = wave_sum(s) * (1.f / DM); float s2 = 0.f;
#pragma unroll
        for (int j = 0; j < 4; ++j) { v[j] = v[j] - mean; s2 += (v[j].x * v[j].x + v[j].y * v[j].y) + (v[j].z * v[j].z + v[j].w * v[j].w); }
        const float rstd = rsqrtf(wave_sum(s2) * (1.f / DM) + LN_EPS);
        unsigned long long* o8 = (unsigned long long*)(F_XB + (size_t)m * DM) + F.lane;
#pragma unroll
        for (int j = 0; j < 4; ++j) { const f32x4 y = v[j] * rstd * gv[j] + bv[j]; xr[64 * j] = y;
            o8[64 * j] = (unsigned long long)pk2(y.x, y.y) | ((unsigned long long)pk2(y.z, y.w) << 32); }
    }
}

__device__ __forceinline__ void conv_mixer(const Frame& F, int l) {
    const float* cw = F.a->in[7] + (size_t)l * 256 * 3;
    const int gt = blockIdx.x * 512 + F.tid, NGT = gridDim.x * 512;
    for (int idx = gt; idx < MTOK * 32; idx += NGT) {
        const int m = idx >> 5, c8 = (idx & 31) * 8, t = m & (SEQ - 1);
        const bf16* hrow = F_H + (size_t)m * INP;
        const u32x4 cb = *(const u32x4*)(hrow + C_CB + c8);
        float acc[8];
#pragma unroll
        for (int i = 0; i < 8; ++i) acc[i] = 0.f;
#pragma unroll
        for (int j = 0; j < 3; ++j) {
            const int tt = t - 2 + j;
            if (tt >= 0) {
                const bf16* hr = hrow + (ptrdiff_t)(j - 2) * INP;
                const u32x4 cc = *(const u32x4*)(hr + C_CC + c8), ch = *(const u32x4*)(hr + C_CH + c8);
#pragma unroll
                for (int q = 0; q < 4; ++q) {
                    acc[2 * q]     += cw[(c8 + 2 * q) * 3 + j]     * (bflo(cc[q]) * bflo(ch[q]));
                    acc[2 * q + 1] += cw[(c8 + 2 * q + 1) * 3 + j] * (bfhi(cc[q]) * bfhi(ch[q]));
                }
            }
        }
        u32x4 o;
#pragma unroll
        for (int q = 0; q < 4; ++q) o[q] = pk2(bflo(cb[q]) * acc[2 * q], bfhi(cb[q]) * acc[2 * q + 1]);
        *(u32x4*)(F_XB + (size_t)m * DM + c8) = o;
    }
}

__device__ __forceinline__ void gdn_prep_group(const Frame& F, int l, int grp) {
    const int tid = F.tid, sub = tid >> 7, lt = tid & 127, c = tid & 63;
    const int w2 = __builtin_amdgcn_readfirstlane((tid >> 6) & 1);
    const int cid = grp * 4 + sub, b = cid >> 7, h = (cid >> 5) & 3, n = cid & 31;
    LAS float* qn = (LAS float*)(F.lds + sub * GP_STRIDE);
    LAS float* kn = qn + 64 * 65;
    LAS float* ms = kn + 64 * 65;
    const size_t m0 = (size_t)b * SEQ + n * 64;
    const bf16* Hb = F_H;
    const float* cw = F.a->in[8] + (size_t)l * 768 * 4;
    unsigned char* rec = F_GD + (size_t)cid * GD_CHUNK;
#define GDN_CONV(COL, WIDX, STORE) do { const float w0_ = cw[(WIDX) * 4 + 0], w1_ = cw[(WIDX) * 4 + 1], w2_ = cw[(WIDX) * 4 + 2], w3_ = cw[(WIDX) * 4 + 3]; \
        const bf16* hp = Hb + m0 * INP + (COL); float r0 = 0.f, r1 = 0.f, r2 = 0.f; \
        if (n > 0) { r0 = bf2f(hp[-3 * (ptrdiff_t)INP]); r1 = bf2f(hp[-2 * (ptrdiff_t)INP]); r2 = bf2f(hp[-1 * (ptrdiff_t)INP]); } \
        _Pragma("unroll") for (int tt = 0; tt < 64; ++tt) { const float r3 = bf2f(hp[(size_t)tt * INP]); float y = w0_ * r0 + w1_ * r1 + w2_ * r2 + w3_ * r3; y = silu_f(y); STORE; r0 = r1; r1 = r2; r2 = r3; \
            if ((tt & 7) == 7) asm volatile("" ::: "memory"); } } while (0)
    if (w2 == 0) GDN_CONV(C_GQ + h * 64 + c, h * 64 + c, qn[tt * 65 + c] = y);
    else         GDN_CONV(C_GK + h * 64 + c, 256 + h * 64 + c, kn[tt * 65 + c] = y);
    __syncthreads();
    {
        const LAS float* src = w2 ? kn : qn; float ss = 0.f;
#pragma unroll 8
        for (int d = 0; d < 64; ++d) { const float v = src[c * 65 + d]; ss += v * v; }
        if (w2 == 0) {
            ms[c] = rsqrtf(ss + NORM_EPS) * 0.125f;
            const float a = bf2f(Hb[(m0 + c) * INP + C_GA + h]);
            const float xx = a + F.a->in[10][l * 4 + h];
            const float sp = xx > 20.f ? xx : log1pf(expf(xx));
            float gcv = -expf(F.a->in[9][l * 4 + h]) * sp;
#pragma unroll
            for (int off = 1; off < 64; off <<= 1) { const float o = __shfl_up(gcv, off); if (c >= off) gcv += o; }
            ms[192 + c] = gcv; ms[256 + c] = expf(gcv);
            if (c == 63) F_GLAST[cid] = gcv;
        } else {
            ms[64 + c] = rsqrtf(ss + NORM_EPS);
            ms[128 + c] = sigmoid_f(bf2f(Hb[(m0 + c) * INP + C_GB + h]));
        }
    }
    __syncthreads();
    {
        LAS float* src = w2 ? kn : qn; const LAS float* sc = w2 ? ms + 64 : ms;
#pragma unroll 8
        for (int t = 0; t < 64; ++t) src[t * 65 + c] *= sc[t];
    }
    __syncthreads();
    const int ty = lt >> 3, tx = lt & 7;
    float aL[4][8], aA[4][8];
#pragma unroll
    for (int i = 0; i < 4; ++i)
#pragma unroll
        for (int j = 0; j < 8; ++j) { aL[i][j] = 0.f; aA[i][j] = 0.f; }
#pragma unroll 2
    for (int d = 0; d < 64; ++d) {
        float kj[8], ki[4], qi[4];
#pragma unroll
        for (int j = 0; j < 8; ++j) kj[j] = kn[(tx + 8 * j) * 65 + d];
#pragma unroll
        for (int i = 0; i < 4; ++i) { ki[i] = kn[(4 * ty + i) * 65 + d]; qi[i] = qn[(4 * ty + i) * 65 + d]; }
#pragma unroll
        for (int i = 0; i < 4; ++i)
#pragma unroll
            for (int j = 0; j < 8; ++j) { aL[i][j] += ki[i] * kj[j]; aA[i][j] += qi[i] * kj[j]; }
    }
#pragma unroll
    for (int i = 0; i < 4; ++i) { const int ri = 4 * ty + i; const float gi = ms[192 + ri], bi = ms[128 + ri];
#pragma unroll
        for (int j = 0; j < 8; ++j) { const int cj = tx + 8 * j; const float dec = (cj <= ri) ? expf(gi - ms[192 + cj]) : 0.f;
            aL[i][j] = (cj < ri) ? bi * aL[i][j] * dec : 0.f; aA[i][j] = aA[i][j] * dec; } }
#define FRAG_OUT(DST, ELEM) do { _Pragma("unroll") for (int it_ = 0; it_ < 4; ++it_) { const int idx = lt + 128 * it_, f_ = idx >> 6, l_ = idx & 63, row = 16 * (f_ >> 1) + (l_ & 15), kb_ = 32 * (f_ & 1) + 4 * (l_ >> 4); \
        u32x4 w_; { int col = kb_; const float e0 = ELEM; col = kb_ + 1; const float e1 = ELEM; w_.x = pk2(e0, e1); } \
        { int col = kb_ + 2; const float e0 = ELEM; col = kb_ + 3; const float e1 = ELEM; w_.y = pk2(e0, e1); } \
        { int col = kb_ + 16; const float e0 = ELEM; col = kb_ + 17; const float e1 = ELEM; w_.z = pk2(e0, e1); } \
        { int col = kb_ + 18; const float e0 = ELEM; col = kb_ + 19; const float e1 = ELEM; w_.w = pk2(e0, e1); } \
        *(u32x4*)((DST) + (size_t)idx * 16) = w_; } } while (0)
    const float glast = ms[192 + 63];
    FRAG_OUT(rec + 8192, qn[row * 65 + col] * ms[256 + row]);
    FRAG_OUT(rec + 24576, kn[col * 65 + row] * expf(glast - ms[192 + col]));
    __syncthreads();
    LAS float* Lm = qn;
    LAS float* Am = kn;
#pragma unroll
    for (int i = 0; i < 4; ++i)
#pragma unroll
        for (int j = 0; j < 8; ++j) { Lm[(4 * ty + i) * 64 + tx + 8 * j] = aL[i][j]; Am[(4 * ty + i) * 65 + tx + 8 * j] = aA[i][j]; }
    __syncthreads();
    FRAG_OUT(rec + 16384, Am[row * 65 + col]);
    float X[64];
    if (w2 == 0) GDN_CONV(C_GV + h * 64 + c, 512 + h * 64 + c, X[tt] = y * ms[128 + tt]);
    else         GDN_CONV(C_GK + h * 64 + c, 256 + h * 64 + c, X[tt] = y * (ms[64 + tt] * ms[128 + tt] * ms[256 + tt]));
#undef GDN_CONV
#pragma unroll
    for (int i = 1; i < 64; ++i) { float s0 = 0.f, s1 = 0.f, s2 = 0.f, s3 = 0.f;
#pragma unroll
        for (int j4 = 0; j4 < (i + 3) / 4; ++j4) { const f32x4 lv = *(const LAS f32x4*)(Lm + i * 64 + j4 * 4);
            s0 += lv.x * X[4 * j4]; s1 += lv.y * X[4 * j4 + 1]; s2 += lv.z * X[4 * j4 + 2]; s3 += lv.w * X[4 * j4 + 3]; }
        X[i] -= (s0 + s1) + (s2 + s3); }
    __syncthreads();
    if (w2 == 0) {
        float* U = (float*)(rec + 32768); const int vs = c >> 4, cl = c & 15;
#pragma unroll
        for (int a = 0; a < 16; ++a) { const f32x4 v = {X[4 * a], X[4 * a + 1], X[4 * a + 2], X[4 * a + 3]};
            *(f32x4*)(U + (size_t)(((vs * 4 + (a >> 2)) * 64 + (a & 3) * 16 + cl) * 4)) = v; }
    } else {
#pragma unroll
        for (int j = 0; j < 64; ++j) Am[j * 65 + c] = X[j];
    }
    __syncthreads();
    FRAG_OUT(rec, Am[row * 65 + col]);
#undef FRAG_OUT
    __syncthreads();
}

__device__ __forceinline__ void nsa_compress_item(const Frame& F, int l, int id) {
    const int b = id >> 5, hk = (id >> 4) & 1, kv = (id >> 3) & 1, rb = id & 7;
    const int lane = F.lane, wave = F.wave, q4 = lane >> 4;
    const bf16* Hsrc = F_H + (size_t)b * SEQ * INP + (kv ? C_VCMP : C_KCMP) + hk * 64;
    const bf16* W1t = kv ? F_WCV : F_WCK;
    int n = 16 * rb + (lane & 15); if (n > 126) n = 126;
    const bf16* arow = Hsrc + (size_t)(16 * n) * INP;
    const bf16* brow = W1t + (size_t)(16 * wave + (lane & 15)) * 2048;
    f32x4 acc = {0.f, 0.f, 0.f, 0.f};
#pragma unroll 8
    for (int ks = 0; ks < 64; ++ks) { const int kk = 32 * ks + 8 * q4;
        const bf16x8 a = *(const bf16x8*)(arow + (size_t)(kk >> 6) * INP + (kk & 63));
        const bf16x8 bb = *(const bf16x8*)(brow + kk);
        acc = __builtin_amdgcn_mfma_f32_16x16x32_bf16(a, bb, acc, 0, 0, 0); }
    LAS float* hid = (LAS float*)F.lds;
    const int j = 16 * wave + (lane & 15); const float pb = F_PEB[kv * 128 + j];
#pragma unroll
    for (int r = 0; r < 4; ++r) hid[(4 * q4 + r) * 132 + j] = silu_f(acc[r] + pb);
    __syncthreads();
    const float* w2 = F.a->in[kv ? 17 : 15] + (size_t)l * 128 * 64;
    const int r = F.tid >> 5, dd = (F.tid & 31) * 2; float o0 = 0.f, o1 = 0.f;
#pragma unroll 8
    for (int jj = 0; jj < 128; ++jj) { const float hv = hid[r * 132 + jj]; o0 += hv * w2[jj * 64 + dd]; o1 += hv * w2[jj * 64 + dd + 1]; }
    const int no = 16 * rb + r; if (no > 126) { o0 = 0.f; o1 = 0.f; }
    bf16* dst = (kv ? F_VC : F_KC) + ((size_t)(b * 2 + hk) * 128 + no) * 64 + dd;
    *(unsigned*)dst = pk2(o0, o1);
    __syncthreads();
}

__device__ __forceinline__ void phase_mixprep(const Frame& F, int l) {
#ifndef NO_GPREP
    for (int grp = blockIdx.x; grp < 256; grp += gridDim.x) gdn_prep_group(F, l, grp);
#endif
#ifndef NO_CMPR
    for (int id = blockIdx.x; id < 256; id += gridDim.x) nsa_compress_item(F, l, id);
#endif
#ifndef NO_CONVMIX
    conv_mixer(F, l);
#endif
}

__device__ __forceinline__ bf16x8 pack8(const f32x4& a, const f32x4& b) {
    u32x4 w; w.x = pk2(a[0], a[1]); w.y = pk2(a[2], a[3]); w.z = pk2(b[0], b[1]); w.w = pk2(b[2], b[3]); return __builtin_bit_cast(bf16x8, w);
}
__device__ __forceinline__ void gdn_scan(const Frame& F, int l, int sid) {
    const int lane = F.lane, wave = F.wave, grp = wave >> 2, vs = wave & 3, q4 = lane >> 4, cl = lane & 15;
    const int bh = sid * 2 + grp, b = bh >> 2, h = bh & 3;
    LAS float* part = (LAS float*)F.lds;
    const float* nw = F.a->in[11] + (size_t)l * 64;
    const float nwv = nw[16 * vs + cl];
    f32x4 S[4];
#pragma unroll
    for (int mb = 0; mb < 4; ++mb) S[mb] = (f32x4){0.f, 0.f, 0.f, 0.f};
    for (int n = 0; n < 32; ++n) {
        const int cid = bh * 32 + n;
        const unsigned char* rec = F_GD + (size_t)cid * GD_CHUNK;
        const bf16x8* pw = (const bf16x8*)rec + lane;
        bf16x8 wA[8], qA[8], aA[8], kA[8];
#pragma unroll
        for (int f = 0; f < 8; ++f) { wA[f] = pw[f * 64]; qA[f] = pw[512 + f * 64]; aA[f] = pw[1024 + f * 64]; kA[f] = pw[1536 + f * 64]; }
        f32x4 u[4];
#pragma unroll
        for (int mb = 0; mb < 4; ++mb) u[mb] = ((const f32x4*)(rec + 32768))[(vs * 4 + mb) * 64 + lane];
        const float egl = expf(F_GLAST[cid]);
        const size_t mrow = (size_t)b * SEQ + n * 64;
        float zv[4][4];
#pragma unroll
        for (int mb = 0; mb < 4; ++mb)
#pragma unroll
            for (int r = 0; r < 4; ++r) zv[mb][r] = bf2f(F_H[(mrow + 16 * mb + 4 * q4 + r) * INP + C_GZ + h * 64 + 16 * vs + cl]);
        const bf16x8 Sb0 = pack8(S[0], S[1]), Sb1 = pack8(S[2], S[3]);
        f32x4 vn[4], o[4];
#pragma unroll
        for (int mb = 0; mb < 4; ++mb) { f32x4 t = {0.f, 0.f, 0.f, 0.f};
            t = __builtin_amdgcn_mfma_f32_16x16x32_bf16(wA[2 * mb], Sb0, t, 0, 0, 0); t = __builtin_amdgcn_mfma_f32_16x16x32_bf16(wA[2 * mb + 1], Sb1, t, 0, 0, 0);
            vn[mb] = u[mb] - t;
            f32x4 oo = {0.f, 0.f, 0.f, 0.f};
            oo = __builtin_amdgcn_mfma_f32_16x16x32_bf16(qA[2 * mb], Sb0, oo, 0, 0, 0); oo = __builtin_amdgcn_mfma_f32_16x16x32_bf16(qA[2 * mb + 1], Sb1, oo, 0, 0, 0);
            o[mb] = oo; }
        const bf16x8 Vb0 = pack8(vn[0], vn[1]), Vb1 = pack8(vn[2], vn[3]);
#pragma unroll
        for (int mb = 0; mb < 4; ++mb) {
            o[mb] = __builtin_amdgcn_mfma_f32_16x16x32_bf16(aA[2 * mb], Vb0, o[mb], 0, 0, 0); o[mb] = __builtin_amdgcn_mfma_f32_16x16x32_bf16(aA[2 * mb + 1], Vb1, o[mb], 0, 0, 0);
            f32x4 sn = S[mb] * egl;
            sn = __builtin_amdgcn_mfma_f32_16x16x32_bf16(kA[2 * mb], Vb0, sn, 0, 0, 0); sn = __builtin_amdgcn_mfma_f32_16x16x32_bf16(kA[2 * mb + 1], Vb1, sn, 0, 0, 0);
            S[mb] = sn; }
        LAS float* pp = part + (n & 1) * 512 + grp * 256;
#pragma unroll
        for (int mb = 0; mb < 4; ++mb)
#pragma unroll
            for (int r = 0; r < 4; ++r) { float s = o[mb][r] * o[mb][r]; s += __shfl_xor(s, 1); s += __shfl_xor(s, 2); s += __shfl_xor(s, 4); s += __shfl_xor(s, 8);
                if (cl == 0) pp[vs * 64 + 16 * mb + 4 * q4 + r] = s; }
        __syncthreads();
#pragma unroll
        for (int mb = 0; mb < 4; ++mb)
#pragma unroll
            for (int r = 0; r < 4; ++r) { const int cr = 16 * mb + 4 * q4 + r; const float ss = (pp[cr] + pp[64 + cr]) + (pp[128 + cr] + pp[192 + cr]);
                const float y = o[mb][r] * rsqrtf(ss * (1.f / 64.f) + NORM_EPS) * nwv * silu_f(zv[mb][r]);
                F_XB[(mrow + cr) * DM + 256 + h * 64 + 16 * vs + cl] = (bf16)f2bf(y); }
    }
    __syncthreads();
}

__device__ __forceinline__ int crow(int r, int hi) { return (r & 3) + 8 * (r >> 2) + 4 * hi; }
#define SBAR() __builtin_amdgcn_sched_barrier(0)
__device__ __forceinline__ void stage_kv(LAS char* kslot, LAS char* vslot, const bf16* Kg, const bf16* Vg, int ld, int wid, int lane) {
    const u32x4 kk = *(const u32x4*)(Kg + (size_t)lane * ld + wid * 8);
    const u32x4 vv = *(const u32x4*)(Vg + (size_t)(16 * (wid & 3) + (lane >> 2)) * ld + (wid >> 2) * 32 + (lane & 3) * 8);
    *(LAS u32x4*)(kslot + wid * 1024 + lane * 16) = kk;
    *(LAS u32x4*)(vslot + wid * 1024 + lane * 16) = vv;
}
__device__ __forceinline__ void qkt(f32x16& p0, f32x16& p1, const LAS char* Kslot, const bf16x8* qr, int r32, int hi) {
    const LAS char* kb = Kslot + hi * 1024 + r32 * 16;
    f32x16 z;
#pragma unroll
    for (int r = 0; r < 16; ++r) z[r] = 0.f;
#pragma unroll
    for (int d0 = 0; d0 < 4; ++d0) {
        const bf16x8 b0 = *(const LAS bf16x8*)(kb + d0 * 2048);
        const bf16x8 b1 = *(const LAS bf16x8*)(kb + d0 * 2048 + 512);
        if (d0 == 0) { p0 = __builtin_amdgcn_mfma_f32_32x32x16_bf16(b0, qr[0], z, 0, 0, 0); p1 = __builtin_amdgcn_mfma_f32_32x32x16_bf16(b1, qr[0], z, 0, 0, 0); }
        else { p0 = __builtin_amdgcn_mfma_f32_32x32x16_bf16(b0, qr[d0], p0, 0, 0, 0); p1 = __builtin_amdgcn_mfma_f32_32x32x16_bf16(b1, qr[d0], p1, 0, 0, 0); } }
}
__device__ __forceinline__ float rowmax32(const f32x16& p0, const f32x16& p1) {
    float a = fmaxf(p0[0], p1[0]);
#pragma unroll
    for (int r = 1; r < 16; ++r) a = fmaxf(a, fmaxf(p0[r], p1[r]));
    auto rr = __builtin_amdgcn_permlane32_swap(__float_as_uint(a), __float_as_uint(a), false, false);
    return fmaxf(__uint_as_float(rr[0]), __uint_as_float(rr[1]));
}
__device__ __forceinline__ float halfswap_sum(float v) {
    auto rr = __builtin_amdgcn_permlane32_swap(__float_as_uint(v), __float_as_uint(v), false, false);
    return __uint_as_float(rr[0]) + __uint_as_float(rr[1]);
}
__device__ __forceinline__ void pv(f32x16* o, int vb, bf16x8 pa0, bf16x8 pa1, bf16x8 pa2, bf16x8 pa3) {
#pragma unroll
    for (int d0 = 0; d0 < 2; ++d0) { s16x4 lo[4], hi[4];
#pragma unroll
        for (int ks = 0; ks < 4; ++ks) {
            asm volatile("ds_read_b64_tr_b16 %0,%1 offset:%c2" : "=&v"(lo[ks]) : "v"(vb), "i"(d0 * 4096 + ks * 1024) : "memory");
            asm volatile("ds_read_b64_tr_b16 %0,%1 offset:%c2" : "=&v"(hi[ks]) : "v"(vb), "i"(d0 * 4096 + ks * 1024 + 512) : "memory"); }
        asm volatile("s_waitcnt lgkmcnt(0)" ::: "memory"); SBAR();
#define PK(k) (bf16x8){lo[k][0], lo[k][1], lo[k][2], lo[k][3], hi[k][0], hi[k][1], hi[k][2], hi[k][3]}
        o[d0] = __builtin_amdgcn_mfma_f32_32x32x16_bf16(pa0, PK(0), o[d0], 0, 0, 0);
        o[d0] = __builtin_amdgcn_mfma_f32_32x32x16_bf16(pa1, PK(1), o[d0], 0, 0, 0);
        o[d0] = __builtin_amdgcn_mfma_f32_32x32x16_bf16(pa2, PK(2), o[d0], 0, 0, 0);
        o[d0] = __builtin_amdgcn_mfma_f32_32x32x16_bf16(pa3, PK(3), o[d0], 0, 0, 0);
#undef PK
    }
}
__device__ __forceinline__ void pv_tile(f32x16* o, int vb, const f32x16& p0, const f32x16& p1) {
    u32x4 w0, w1, w2, w3;
#pragma unroll
    for (int q = 0; q < 4; ++q) { w0[q] = pk2(p0[2 * q], p0[2 * q + 1]); w1[q] = pk2(p0[8 + 2 * q], p0[9 + 2 * q]); w2[q] = pk2(p1[2 * q], p1[2 * q + 1]); w3[q] = pk2(p1[8 + 2 * q], p1[9 + 2 * q]); }
    pv(o, vb, __builtin_bit_cast(bf16x8, w0), __builtin_bit_cast(bf16x8, w1), __builtin_bit_cast(bf16x8, w2), __builtin_bit_cast(bf16x8, w3));
}
__device__ __forceinline__ void row_factors(float (&fr)[16], float f, LAS float* wsf, int r32, int hi) {
    asm volatile("s_waitcnt lgkmcnt(0)" ::: "memory");
    if (hi == 0) wsf[r32] = f;
    asm volatile("s_waitcnt lgkmcnt(0)" ::: "memory");
#pragma unroll
    for (int r = 0; r < 16; ++r) fr[r] = wsf[crow(r, hi)];
    asm volatile("s_waitcnt lgkmcnt(0)" ::: "memory");
}
struct AttnState { float m, l; f32x16 o[2]; };
__device__ __forceinline__ void attn_reset(AttnState& st) {
    st.m = -INFINITY; st.l = 0.f;
#pragma unroll
    for (int r = 0; r < 16; ++r) { st.o[0][r] = 0.f; st.o[1][r] = 0.f; }
}
__device__ __forceinline__ void attn_tile(AttnState& st, f32x16& p0, f32x16& p1, int vb, LAS float* wsf, int r32, int hi) {
    const float rm = rowmax32(p0, p1);
    const float mnew = fmaxf(st.m, rm);
    const float muse = (mnew == -INFINITY) ? 0.f : mnew;
    const float alpha = __builtin_amdgcn_exp2f((st.m - muse) * C2);
    float sum = 0.f;
#pragma unroll
    for (int r = 0; r < 16; ++r) { p0[r] = __builtin_amdgcn_exp2f((p0[r] - muse) * C2); p1[r] = __builtin_amdgcn_exp2f((p1[r] - muse) * C2); sum += p0[r] + p1[r]; }
    st.l = st.l * alpha + sum; st.m = mnew;
    float fr[16]; row_factors(fr, alpha, wsf, r32, hi);
#pragma unroll
    for (int r = 0; r < 16; ++r) { st.o[0][r] *= fr[r]; st.o[1][r] *= fr[r]; }
    pv_tile(st.o, vb, p0, p1);
}
__device__ __forceinline__ void attn_accum(LAS float* stg, AttnState& st, float gate, bool first, LAS float* wsf, int r32, int hi) {
    const float lt = halfswap_sum(st.l);
    const float f = lt > 0.f ? gate / lt : 0.f;
    float fr[16]; row_factors(fr, f, wsf, r32, hi);
#pragma unroll
    for (int r = 0; r < 16; ++r) { const int orow = crow(r, hi); float a0 = st.o[0][r] * fr[r], a1 = st.o[1][r] * fr[r];
        if (!first) { a0 += stg[orow * 64 + r32]; a1 += stg[orow * 64 + 32 + r32]; }
        stg[orow * 64 + r32] = a0; stg[orow * 64 + 32 + r32] = a1; }
}

__device__ __forceinline__ void nsa_item(const Frame& F, int b, int hk, int qb) {
    const int tid = F.tid, lane = F.lane, r32 = lane & 31, hi = lane >> 5, wid = F.wave;
    const int tokl = wid * 8 + (r32 >> 2), g = r32 & 3, tpos = qb * 64 + tokl;
    const size_t mrow = (size_t)b * SEQ + tpos;
    LAS char* const L = (LAS char*)F.lds;
    LAS float* wsf = (LAS float*)(L + AT_WSF) + wid * 64;
    LAS float* IMPO = (LAS float*)(L + AT_IMPO); LAS float* IMPS = (LAS float*)(L + AT_IMPS);
    LAS unsigned* SEL = (LAS unsigned*)(L + AT_SEL);
    LAS float* GATE = (LAS float*)(L + AT_GATE);
    const int vb0 = (int)(unsigned)(size_t)(L + AT_V) + ((lane >> 4) & 1) * 32 + (lane & 3) * 8 + (4 * hi + ((lane & 15) >> 2)) * 64;
    const bf16* Hb = F_H;
    bf16x8 qr[4];
#pragma unroll
    for (int d0 = 0; d0 < 4; ++d0) qr[d0] = *(const bf16x8*)(Hb + mrow * INP + C_NQ + (hk * 4 + g) * 64 + d0 * 16 + hi * 8);
    __syncthreads();
    if (tid < 256) { const int tk = (tid >> 5) * 8 + ((tid & 31) >> 2), gg = tid & 3; const bf16* gp = Hb + ((size_t)b * SEQ + qb * 64 + tk) * INP + C_NG + (hk * 4 + gg) * 3;
        GATE[tid * 4 + 0] = sigmoid_f(bf2f(gp[0])); GATE[tid * 4 + 1] = sigmoid_f(bf2f(gp[1])); GATE[tid * 4 + 2] = sigmoid_f(bf2f(gp[2])); }
    { const bf16* kcb = F_KC + (size_t)(b * 2 + hk) * 128 * 64; const bf16* vcb = F_VC + (size_t)(b * 2 + hk) * 128 * 64;
      stage_kv(L + AT_K, L + AT_V, kcb, vcb, 64, wid, lane);
      stage_kv(L + AT_K + 8192, L + AT_V + 8192, kcb + 64 * 64, vcb + 64 * 64, 64, wid, lane); }
    __syncthreads();
    LAS float* stgf = (LAS float*)(L + AT_OST) + wid * 2048;
    const float g0 = GATE[(wid * 32 + r32) * 4 + 0], g1 = GATE[(wid * 32 + r32) * 4 + 1], g2 = GATE[(wid * 32 + r32) * 4 + 2];
    {
        f32x16 pA0, pA1, pB0, pB1;
        qkt(pA0, pA1, L + AT_K, qr, r32, hi); qkt(pB0, pB1, L + AT_K + 8192, qr, r32, hi);
        const int nmax = tpos >= 31 ? ((tpos - 31) >> 4) : -1;
#pragma unroll
        for (int r = 0; r < 16; ++r) { const int n0 = crow(r, hi);
            if (n0 > nmax) pA0[r] = -INFINITY; if (n0 + 32 > nmax) pA1[r] = -INFINITY; if (n0 + 64 > nmax) pB0[r] = -INFINITY; if (n0 + 96 > nmax) pB1[r] = -INFINITY; }
        const float m = fmaxf(rowmax32(pA0, pA1), rowmax32(pB0, pB1));
        const float muse = (m == -INFINITY) ? 0.f : m;
        float sum = 0.f;
#pragma unroll
        for (int r = 0; r < 16; ++r) { pA0[r] = __builtin_amdgcn_exp2f((pA0[r] - muse) * C2); pA1[r] = __builtin_amdgcn_exp2f((pA1[r] - muse) * C2);
            pB0[r] = __builtin_amdgcn_exp2f((pB0[r] - muse) * C2); pB1[r] = __builtin_amdgcn_exp2f((pB1[r] - muse) * C2); sum += (pA0[r] + pA1[r]) + (pB0[r] + pB1[r]); }
        const float lt = halfswap_sum(sum);
        const float inv = lt > 0.f ? 1.0f / lt : 0.f;
#pragma unroll
        for (int r = 0; r < 16; ++r) { pA0[r] *= inv; pA1[r] *= inv; pB0[r] *= inv; pB1[r] *= inv; }
#define IMP_PART(P, JB) do { _Pragma("unroll") for (int a = 0; a < 4; ++a) { float own = (P[4 * a] + P[4 * a + 1]) + (P[4 * a + 2] + 0.5f * P[4 * a + 3]); float sp = 0.5f * P[4 * a + 3]; \
            own += __shfl_xor(own, 1); own += __shfl_xor(own, 2); sp += __shfl_xor(sp, 1); sp += __shfl_xor(sp, 2); \
            if (g == 0) { const int j = (JB) + 2 * a + hi; IMPO[tokl * 33 + j] = own; IMPS[tokl * 33 + j + 1] = sp; } } } while (0)
        IMP_PART(pA0, 0); IMP_PART(pA1, 8); IMP_PART(pB0, 16); IMP_PART(pB1, 24);
#undef IMP_PART
        AttnState st; attn_reset(st);
        pv_tile(st.o, vb0, pA0, pA1); pv_tile(st.o, vb0 + 8192, pB0, pB1);
        st.l = 0.5f;
        attn_accum(stgf, st, g0, true, wsf, r32, hi);
    }
    __syncthreads();
    if (tid < 64) {
        LAS float* io = IMPO + tid * 33; const LAS float* is = IMPS + tid * 33;
        for (int j = 0; j < 32; ++j) { float v = io[j] + (j > 0 ? is[j] : 0.f);
            if (j == 0 || j == qb || j == qb - 1) v += 1000.f;
            if (j > qb) v = -1e30f;
            io[j] = v; }
        unsigned mask = 0u;
        for (int it = 0; it < 8; ++it) { float best = -INFINITY; int bj = 0;
            for (int j = 0; j < 32; ++j) { const float v = io[j]; if (v > best) { best = v; bj = j; } }
            mask |= 1u << bj; io[bj] = -INFINITY; }
        mask &= (qb >= 31) ? 0xffffffffu : ((2u << qb) - 1u);
        SEL[tid] = mask;
        unsigned un = mask;
#pragma unroll
        for (int o = 1; o < 64; o <<= 1) un |= (unsigned)__shfl_xor((int)un, o);
        if (tid == 0) SEL[64] = un;
    }
    __syncthreads();
    const unsigned selmask = SEL[tokl], unionmask = SEL[64];
    {
        AttnState st; attn_reset(st);
        for (int j = 0; j <= qb; ++j) {
            if (!((unionmask >> j) & 1u)) continue;
            __syncthreads();
            { const bf16* kg = Hb + ((size_t)b * SEQ + j * 64) * INP + hk * 64; stage_kv(L + AT_K, L + AT_V, kg + C_KSLC, kg + C_VSLC, INP, wid, lane); }
            __syncthreads();
            const bool mine = (selmask >> j) & 1u;
            if (__any(mine)) {
                f32x16 p0, p1; qkt(p0, p1, L + AT_K, qr, r32, hi);
                const int lim = mine ? (j == qb ? tokl : 63) : -1;
#pragma unroll
                for (int r = 0; r < 16; ++r) { const int kv = crow(r, hi); if (kv > lim) p0[r] = -INFINITY; if (kv + 32 > lim) p1[r] = -INFINITY; }
                attn_tile(st, p0, p1, vb0, wsf, r32, hi);
            }
        }
        attn_accum(stgf, st, g1, false, wsf, r32, hi);
    }
    {
        AttnState st; attn_reset(st);
        for (int j = qb; j >= 0 && j >= qb - 8; --j) {
            __syncthreads();
            { const bf16* kg = Hb + ((size_t)b * SEQ + j * 64) * INP + hk * 64; stage_kv(L + AT_K, L + AT_V, kg + C_KWIN, kg + C_VWIN, INP, wid, lane); }
            __syncthreads();
            f32x16 p0, p1; qkt(p0, p1, L + AT_K, qr, r32, hi);
            if (j == qb || j == qb - 8) {
                const int hi_lim = (j == qb) ? tokl : 63;
                const int lo_lim = (j == qb - 8) ? tokl + 1 : 0;
#pragma unroll
                for (int r = 0; r < 16; ++r) { const int kv = crow(r, hi);
                    if (kv > hi_lim || kv < lo_lim) p0[r] = -INFINITY; if (kv + 32 > hi_lim || kv + 32 < lo_lim) p1[r] = -INFINITY; }
            }
            attn_tile(st, p0, p1, vb0, wsf, r32, hi);
        }
        attn_accum(stgf, st, g2, false, wsf, r32, hi);
    }
    {
        asm volatile("s_waitcnt lgkmcnt(0)" ::: "memory");
#pragma unroll
        for (int i = 0; i < 4; ++i) { const int row = i * 8 + (lane >> 3), ch = lane & 7;
            const f32x4 a = *(const LAS f32x4*)(stgf + row * 64 + ch * 8), c4 = *(const LAS f32x4*)(stgf + row * 64 + ch * 8 + 4);
            u32x4 v; v.x = pk2(a[0], a[1]); v.y = pk2(a[2], a[3]); v.z = pk2(c4[0], c4[1]); v.w = pk2(c4[2], c4[3]);
            bf16* dst = F_XB + ((size_t)b * SEQ + qb * 64 + wid * 8 + (row >> 2)) * DM + 512 + (hk * 4 + (row & 3)) * 64 + ch * 8;
            *(u32x4*)dst = v; }
        asm volatile("s_waitcnt lgkmcnt(0)" ::: "memory");
    }
}

constexpr int N_SCAN_WG = 16;
__device__ __forceinline__ void phase_mixseq(const Frame& F, int l) {
#ifndef NO_SCAN
    if ((int)blockIdx.x < N_SCAN_WG) { gdn_scan(F, l, blockIdx.x); return; }
#endif
    const int aw = blockIdx.x - N_SCAN_WG, naw = gridDim.x - N_SCAN_WG;
#ifndef NO_ATT
    for (int it = aw; it < 512; it += naw) { const int qb = 31 - (it >> 4), bhk = it & 15; nsa_item(F, bhk >> 1, bhk & 1, qb); }
#endif
    __syncthreads();
}

template <class Epi> __device__ __forceinline__ void run_gemm(LAS unsigned char* lds, const bf16* A, const bf16* Bt, int N, int K, const Epi& E) {
    pg8::Gemm g{A, Bt, MTOK, N, K}; pg8::StaticOrder S; S.init(MTOK, N, (int)gridDim.x, (int)blockIdx.x);
    pg8::gemm_phase<Epi, pg8::StaticOrder, true, true>(lds, g, S, E);
}

__global__ void __launch_bounds__(512, 2) fwd_kernel(Args args) {
    extern __shared__ __attribute__((aligned(16))) unsigned char lds_raw[];
    Frame F;
    F.lds = (LAS unsigned char*)lds_raw;
    F.a = &args;
    cg::grid_group grid = cg::this_grid();
#ifndef PH_MASK
#define PH_MASK 0xFFF
#endif
#define PHON(b) ((PH_MASK >> (b)) & 1)
    for (int ph = args.ph_lo; ph < args.ph_hi; ++ph) {
        const int l = ph / NPH, k = ph % NPH;
        { int t_ = threadIdx.x; asm volatile("" : "+v"(t_)); F.tid = t_; F.lane = t_ & 63; F.wave = __builtin_amdgcn_readfirstlane(t_ >> 6);
          unsigned char* w_ = args.ws; float* x_ = args.out; asm volatile("" : "+s"(w_), "+s"(x_)); F.ws = w_; F.X = x_; }
        if (k == 0) { if (PHON(0)) phase_prep(F, l); }
        else if ((k == 1 || k == 9) && PHON(1)) { pg8::EpiSwiGLU E{F_H, DFF}; run_gemm(F.lds, F_XB, k == 1 ? F_WGU1 : F_WGU2, 2 * DFF, DM, E); }
        else if ((k == 2 || k == 10 || k == 7) && PHON(2)) {
            const bool op = (k == 7);
            pg8::EpiRes E{(l == 0 && k == 2) ? args.in[0] : F.X, F.X, DM, ALPHA, op ? 1.0f : 0.5f};
            run_gemm(F.lds, op ? F_XB : F_H, op ? F_WOUT : (k == 2 ? F_WD1 : F_WD2), DM, op ? DM : DFF, E); }
        else if (k == 4 && PHON(4)) { pg8::EpiStoreBf16 E{F_H, INP}; run_gemm(F.lds, F_XB, F_WIN, INP, DM, E); }
        else if ((k == 3 || k == 8 || k == 11) && PHON(3)) { const int gi = (k == 3) ? 4 : (k == 8 ? 19 : 24); phase_ln(F, args.in[gi] + (size_t)l * DM, args.in[gi + 1] + (size_t)l * DM); }
        else if (k == 5 && PHON(5)) phase_mixprep(F, l);
        else if (k == 6 && PHON(6)) phase_mixseq(F, l);
        if (ph + 1 < args.ph_hi) grid.sync();
    }
}

#ifndef N_LAUNCH_MODE
#define N_LAUNCH_MODE 0
#endif
extern "C" void kernel_launch(void* const* d_in, const int* in_sizes, int n_in, void* d_out, int out_size, void* d_ws, size_t ws_size, hipStream_t stream) {
    static int grid = 0;
    if (grid == 0) {
        int dev = 0, cus = 0, per_cu = 0;
        hipGetDevice(&dev); hipDeviceGetAttribute(&cus, hipDeviceAttributeMultiprocessorCount, dev);
        hipFuncSetAttribute((const void*)fwd_kernel, hipFuncAttributeMaxDynamicSharedMemorySize, LDS_BYTES);
        hipOccupancyMaxActiveBlocksPerMultiprocessor(&per_cu, (const void*)fwd_kernel, 512, LDS_BYTES);
        (void)hipGetLastError();
        if (per_cu < 1) per_cu = 1;
        grid = cus;
        if (n_in != 26 || ws_size < WS_END) { fprintf(stderr, "kernel_launch: unexpected inputs (n_in %d, ws %zu)\n", n_in, ws_size); }
    }
    Args a{};
    for (int i = 0; i < 26; ++i) a.in[i] = (const float*)d_in[i];
    a.out = (float*)d_out; a.ws = (unsigned char*)d_ws;
#if N_LAUNCH_MODE == 1
    a.ph_lo = 0; a.ph_hi = DEPTH * NPH;
    void* kargs[] = {&a};
    hipError_t e = hipLaunchCooperativeKernel((const void*)fwd_kernel, dim3(grid), dim3(512), kargs, LDS_BYTES, stream);
    if (e != hipSuccess) fprintf(stderr, "cooperative launch failed: %s (grid %d)\n", hipGetErrorString(e), grid);
#else
    for (int ph = 0; ph < DEPTH * NPH; ++ph) { a.ph_lo = ph; a.ph_hi = ph + 1; hipLaunchKernelGGL(fwd_kernel, dim3(grid), dim3(512), LDS_BYTES, stream, a); }
#endif
}
```
